# Optimizing an MI355X kernel written in HIP

```python
import math
import jax, jax.numpy as jnp
from jax import lax
import numpy as np

D_MODEL = 1024
BATCH = 2
SEQ = 8192
DEPTH = 1

N_META = 16
MIX_WIDTH = D_MODEL
ATTN_WIDTH = MIX_WIDTH // 2
CONV_WIDTH = MIX_WIDTH - ATTN_WIDTH
HEAD_DIM = 64
N_HEADS = ATTN_WIDTH // HEAD_DIM
N_KV_HEADS = 2
GROUP = N_HEADS // N_KV_HEADS
KV_WIDTH = N_KV_HEADS * HEAD_DIM
WINDOW = 128
BLOCK = 128
CONV_K = 31
N_CONV_GROUPS = CONV_WIDTH // HEAD_DIM
D_FF = int(math.ceil(8 * D_MODEL / 3 / 256) * 256)
IN_COLS = ATTN_WIDTH + 2 * KV_WIDTH + 2 * CONV_WIDTH
SPLITS = (ATTN_WIDTH,
          ATTN_WIDTH + KV_WIDTH,
          ATTN_WIDTH + 2 * KV_WIDTH,
          ATTN_WIDTH + 2 * KV_WIDTH + CONV_WIDTH)
NORM_EPS = 1e-5

kernel_name = "hymba_conformer_swa_sink_alibi_layer"


def rmsnorm(x, g):
    xf = x.astype(jnp.float32)
    y = xf * lax.rsqrt(jnp.mean(xf * xf, axis=-1, keepdims=True) + NORM_EPS)
    return (y * g.astype(jnp.float32)).astype(x.dtype)


def alibi_slopes():
    return jnp.power(2.0, -(8.0 / N_HEADS) * jnp.arange(1, N_HEADS + 1, dtype=jnp.float32))


def swa_sink_alibi_attention(q, k, v, sinks):
    B, L = q.shape[0], q.shape[1]
    lead = BLOCK - N_META
    P = L + lead
    nb = P // BLOCK
    pad = ((0, 0), (lead, 0), (0, 0), (0, 0))
    qb = jnp.pad(q, pad).reshape(B, nb, BLOCK, N_KV_HEADS, GROUP, HEAD_DIM)
    kb = jnp.pad(k, pad).reshape(B, nb, BLOCK, N_KV_HEADS, HEAD_DIM)
    vb = jnp.pad(v, pad).reshape(B, nb, BLOCK, N_KV_HEADS, HEAD_DIM)
    shift = ((0, 0), (1, 0), (0, 0), (0, 0), (0, 0))
    k_band = jnp.concatenate([jnp.pad(kb, shift)[:, :-1], kb], axis=2)
    v_band = jnp.concatenate([jnp.pad(vb, shift)[:, :-1], vb], axis=2)
    k_meta = jnp.broadcast_to(k[:, None, :N_META], (B, nb, N_META, N_KV_HEADS, HEAD_DIM))
    v_meta = jnp.broadcast_to(v[:, None, :N_META], (B, nb, N_META, N_KV_HEADS, HEAD_DIM))
    k_all = jnp.concatenate([k_meta, k_band], axis=2)
    v_all = jnp.concatenate([v_meta, v_band], axis=2)

    scale = 1.0 / math.sqrt(HEAD_DIM)
    s = jnp.einsum('bnqkgd,bnskd->bnkgqs', qb, k_all).astype(jnp.float32) * scale

    qi = jnp.arange(nb)[:, None] * BLOCK + jnp.arange(BLOCK)[None, :]
    kj = (jnp.arange(nb)[:, None] - 1) * BLOCK + jnp.arange(2 * BLOCK)[None, :]
    dist = qi[:, :, None] - kj[:, None, :]
    band_ok = (dist >= 0) & (dist < WINDOW) & (kj[:, None, :] >= BLOCK)
    meta_j = lead + jnp.arange(N_META)
    meta_ok = meta_j[None, None, :] <= qi[:, :, None]
    ok = jnp.concatenate([meta_ok, band_ok], axis=-1)
    dist_all = jnp.concatenate(
        [jnp.zeros((nb, BLOCK, N_META), jnp.float32), dist.astype(jnp.float32)], axis=-1)
    slopes = alibi_slopes().reshape(N_KV_HEADS, GROUP)
    bias = -slopes[None, :, :, None, None] * dist_all[:, None, None, :, :]
    s = jnp.where(ok[:, None, None], s + bias[None], -jnp.inf)

    sink = sinks.astype(jnp.float32).reshape(N_KV_HEADS, GROUP)[None, None, :, :, None, None]
    sink = jnp.broadcast_to(sink, s.shape[:-1] + (1,))
    p = jax.nn.softmax(jnp.concatenate([s, sink], axis=-1), axis=-1)[..., :-1]
    o = jnp.einsum('bnkgqs,bnskd->bnqkgd', p.astype(v.dtype), v_all)
    return o.reshape(B, P, N_HEADS * HEAD_DIM)[:, lead:]


def conformer_conv(a, gate, conv_w, conv_b, ln_g, ln_b):
    u = a * jax.nn.sigmoid(gate)
    y = lax.conv_general_dilated(
        u, conv_w[:, None, :].astype(u.dtype), window_strides=(1,),
        padding=((CONV_K - 1, 0),), dimension_numbers=('NWC', 'WIO', 'NWC'),
        feature_group_count=CONV_WIDTH) + conv_b
    yf = y.astype(jnp.float32)
    mu = jnp.mean(yf, axis=-1, keepdims=True)
    var = jnp.mean(jnp.square(yf - mu), axis=-1, keepdims=True)
    yn = (yf - mu) * lax.rsqrt(var + NORM_EPS) * ln_g.astype(jnp.float32) + ln_b.astype(jnp.float32)
    return jax.nn.silu(yn).astype(a.dtype)


def setup_inputs(seed: int = 0) -> dict:
    key = jax.random.key(seed)
    ks = jax.random.split(key, 20)
    f32 = jnp.float32
    nrm = lambda k, shape, s: jax.random.normal(k, shape, f32) * s
    return {
        "x": nrm(ks[0], (BATCH, SEQ, D_MODEL), 1.0),
        "meta_tokens": nrm(ks[1], (N_META, D_MODEL), 1.0),
        "attn_norm_g": 1.0 + nrm(ks[2], (DEPTH, D_MODEL), 0.02),
        "w_in": nrm(ks[3], (DEPTH, D_MODEL, IN_COLS), D_MODEL ** -0.5),
        "attn_sinks": nrm(ks[4], (DEPTH, N_HEADS), 0.5),
        "conv_w": nrm(ks[5], (DEPTH, CONV_K, CONV_WIDTH), CONV_K ** -0.5),
        "conv_b": nrm(ks[6], (DEPTH, CONV_WIDTH), 0.02),
        "conv_ln_g": 1.0 + nrm(ks[7], (DEPTH, CONV_WIDTH), 0.02),
        "conv_ln_b": nrm(ks[8], (DEPTH, CONV_WIDTH), 0.02),
        "attn_out_g": 1.0 + nrm(ks[9], (DEPTH, ATTN_WIDTH), 0.02),
        "conv_out_g": 1.0 + nrm(ks[10], (DEPTH, CONV_WIDTH), 0.02),
        "w_out": nrm(ks[11], (DEPTH, MIX_WIDTH, D_MODEL), MIX_WIDTH ** -0.5),
        "ffn_norm_g": 1.0 + nrm(ks[12], (DEPTH, D_MODEL), 0.02),
        "w_gate": nrm(ks[13], (DEPTH, D_MODEL, D_FF), D_MODEL ** -0.5),
        "w_up": nrm(ks[14], (DEPTH, D_MODEL, D_FF), D_MODEL ** -0.5),
        "w_down": nrm(ks[15], (DEPTH, D_FF, D_MODEL), D_FF ** -0.5),
        "final_norm_g": 1.0 + nrm(ks[16], (D_MODEL,), 0.02),
    }


def reference(x, meta_tokens, attn_norm_g, w_in, attn_sinks, conv_w, conv_b, conv_ln_g,
              conv_ln_b, attn_out_g, conv_out_g, w_out, ffn_norm_g, w_gate, w_up, w_down,
              final_norm_g):
    B = x.shape[0]
    meta = jnp.broadcast_to(meta_tokens[None].astype(x.dtype), (B, N_META, D_MODEL))
    h = jnp.concatenate([meta, x], axis=1)
    L = h.shape[1]
    for l in range(DEPTH):
        hn = rmsnorm(h, attn_norm_g[l])
        proj = hn @ w_in[l]
        q, k, v, ca, cg = jnp.split(proj, SPLITS, axis=-1)
        q = q.reshape(B, L, N_HEADS, HEAD_DIM)
        k = k.reshape(B, L, N_KV_HEADS, HEAD_DIM)
        v = v.reshape(B, L, N_KV_HEADS, HEAD_DIM)
        o_attn = swa_sink_alibi_attention(q, k, v, attn_sinks[l])
        o_conv = conformer_conv(ca, cg, conv_w[l], conv_b[l], conv_ln_g[l], conv_ln_b[l])
        mixed = jnp.concatenate([rmsnorm(o_attn, attn_out_g[l]),
                                 rmsnorm(o_conv, conv_out_g[l])], axis=-1)
        h = h + mixed @ w_out[l]
        hn = rmsnorm(h, ffn_norm_g[l])
        h = h + (jax.nn.silu(hn @ w_gate[l]) * (hn @ w_up[l])) @ w_down[l]
    return rmsnorm(h, final_norm_g)[:, N_META:]
```

```cpp
#include <hip/hip_runtime.h>
#include <stdint.h>

typedef unsigned short bf16_t;
typedef short bf16x8 __attribute__((ext_vector_type(8)));
typedef float f32x4 __attribute__((ext_vector_type(4)));

constexpr int DM = 1024, BATCH = 2, SEQ = 8192, NMETA = 16;
constexpr int MROWS = BATCH * SEQ;
constexpr int MPAD = MROWS + 256;
constexpr int INC = 1792, DFF = 2816, CW = 512, AW = 512;
constexpr int QOFF = 0, KOFF = 512, VOFF = 640, CAOFF = 768, CGOFF = 1280;
constexpr float EPS = 1e-5f;

constexpr size_t MiB = 1u << 20;
constexpr size_t WS_WIN = 2 * MiB, WS_WOUT = 6 * MiB, WS_WGU = 8 * MiB, WS_WDN = 19 * MiB;
constexpr size_t WS_XN = 28 * MiB, WS_PROJ = 61 * MiB, WS_MIXED = 118 * MiB, WS_ACT = 61 * MiB, WS_OATT = 150 * MiB;

__device__ __forceinline__ unsigned f2bf(float f) { unsigned u = __float_as_uint(f); return (u + 0x7fffu + ((u >> 16) & 1u)) >> 16; }
__device__ __forceinline__ float bf2f(unsigned h) { return __uint_as_float(h << 16); }
__device__ __forceinline__ float wave_sum(float v) {
#pragma unroll
    for (int o = 1; o < 64; o <<= 1) v += __shfl_xor(v, o);
    return v;
}
__device__ __forceinline__ float wave_max(float v) {
#pragma unroll
    for (int o = 1; o < 64; o <<= 1) v = fmaxf(v, __shfl_xor(v, o));
    return v;
}

__global__ void k_transpose(const float* __restrict__ W, int K, int N, bf16_t* __restrict__ Wt, int row_off) {
    __shared__ float tile[32][33];
    const int n0 = blockIdx.x * 32, k0 = blockIdx.y * 32, tx = threadIdx.x, ty = threadIdx.y;
    for (int i = ty; i < 32; i += 8) tile[i][tx] = W[(size_t)(k0 + i) * N + n0 + tx];
    __syncthreads();
    for (int i = ty; i < 32; i += 8) Wt[(size_t)(row_off + n0 + i) * K + k0 + tx] = (bf16_t)f2bf(tile[tx][i]);
}

__global__ void k_rms_in(const float* __restrict__ x, const float* __restrict__ meta, const float* __restrict__ g, bf16_t* __restrict__ XN) {
    const int r = blockIdx.x * 4 + (threadIdx.x >> 6), lane = threadIdx.x & 63;
    if (r >= MPAD) return;
    bf16_t* o = XN + (size_t)r * DM;
    if (r >= MROWS + NMETA) { for (int i = lane; i < DM; i += 64) o[i] = 0; return; }
    const float* src = r < MROWS ? x + (size_t)r * DM : meta + (size_t)(r - MROWS) * DM;
    float v[16]; float s = 0.f;
#pragma unroll
    for (int i = 0; i < 16; ++i) { v[i] = src[lane + 64 * i]; s += v[i] * v[i]; }
    const float rs = rsqrtf(wave_sum(s) * (1.f / DM) + EPS);
#pragma unroll
    for (int i = 0; i < 16; ++i) o[lane + 64 * i] = (bf16_t)f2bf(v[i] * rs * g[lane + 64 * i]);
}

template <bool OUT_BF16>
__global__ void k_rms_row(const float* src, const float* __restrict__ g, void* dst) {
    const int r = blockIdx.x * 4 + (threadIdx.x >> 6), lane = threadIdx.x & 63;
    if (r >= MROWS) return;
    const float* s_ = src + (size_t)r * DM;
    float v[16]; float s = 0.f;
#pragma unroll
    for (int i = 0; i < 16; ++i) { v[i] = s_[lane + 64 * i]; s += v[i] * v[i]; }
    const float rs = rsqrtf(wave_sum(s) * (1.f / DM) + EPS);
#pragma unroll
    for (int i = 0; i < 16; ++i) {
        const float o = v[i] * rs * g[lane + 64 * i];
        if (OUT_BF16) ((bf16_t*)dst)[(size_t)r * DM + lane + 64 * i] = (bf16_t)f2bf(o);
        else ((float*)dst)[(size_t)r * DM + lane + 64 * i] = o;
    }
}

template <int MODE>
__global__ void __launch_bounds__(256) k_gemm(const bf16_t* __restrict__ A, const bf16_t* __restrict__ Bt, const bf16_t* __restrict__ Bt2, int K,
                                              void* Cout, int ldc, const float* resid) {
    const int wid = threadIdx.x >> 6, lane = threadIdx.x & 63, wr = wid >> 1, wc = wid & 1;
    const int row0 = blockIdx.y * 128 + wr * 64, col0 = blockIdx.x * 128 + wc * 64;
    const int fr = lane & 15, fq = lane >> 4;
    f32x4 acc[4][4], acc2[4][4];
#pragma unroll
    for (int i = 0; i < 4; ++i)
#pragma unroll
        for (int j = 0; j < 4; ++j) { acc[i][j] = (f32x4){0.f, 0.f, 0.f, 0.f}; acc2[i][j] = (f32x4){0.f, 0.f, 0.f, 0.f}; }
    const bf16_t* ap = A + (size_t)(row0 + fr) * K + fq * 8;
    const bf16_t* bp = Bt + (size_t)(col0 + fr) * K + fq * 8;
    const bf16_t* bp2 = MODE == 2 ? Bt2 + (size_t)(col0 + fr) * K + fq * 8 : nullptr;
    for (int k = 0; k < K; k += 32) {
        bf16x8 a[4], b[4], b2[4];
#pragma unroll
        for (int i = 0; i < 4; ++i) a[i] = *(const bf16x8*)(ap + (size_t)i * 16 * K + k);
#pragma unroll
        for (int j = 0; j < 4; ++j) b[j] = *(const bf16x8*)(bp + (size_t)j * 16 * K + k);
        if (MODE == 2) {
#pragma unroll
            for (int j = 0; j < 4; ++j) b2[j] = *(const bf16x8*)(bp2 + (size_t)j * 16 * K + k);
        }
#pragma unroll
        for (int i = 0; i < 4; ++i)
#pragma unroll
            for (int j = 0; j < 4; ++j) {
                acc[i][j] = __builtin_amdgcn_mfma_f32_16x16x32_bf16(a[i], b[j], acc[i][j], 0, 0, 0);
                if (MODE == 2) acc2[i][j] = __builtin_amdgcn_mfma_f32_16x16x32_bf16(a[i], b2[j], acc2[i][j], 0, 0, 0);
            }
    }
#pragma unroll
    for (int i = 0; i < 4; ++i)
#pragma unroll
        for (int j = 0; j < 4; ++j)
#pragma unroll
            for (int r = 0; r < 4; ++r) {
                const int row = row0 + i * 16 + fq * 4 + r, col = col0 + j * 16 + fr;
                const size_t o = (size_t)row * ldc + col;
                const float v = acc[i][j][r];
                if (MODE == 0) ((bf16_t*)Cout)[o] = (bf16_t)f2bf(v);
                else if (MODE == 1) ((float*)Cout)[o] = resid[o] + v;
                else { const float g = v, u = acc2[i][j][r]; ((bf16_t*)Cout)[o] = (bf16_t)f2bf(g / (1.f + __expf(-g)) * u); }
            }
}

__global__ void __launch_bounds__(512) k_attn(const bf16_t* __restrict__ PROJ, const float* __restrict__ sinks, const float* __restrict__ og, bf16_t* __restrict__ MIXED) {
    __shared__ float red[8];
    const int row = blockIdx.x, b = row / SEQ, t = row % SEQ;
    const int h = threadIdx.x >> 6, lane = threadIdx.x & 63, kvh = h >> 2;
    const float slope = exp2f(-(float)(h + 1));
    float q[64];
    {
        const bf16_t* qp = PROJ + (size_t)row * INC + QOFF + h * 64;
#pragma unroll
        for (int d = 0; d < 64; ++d) q[d] = bf2f(qp[d]);
    }
    float sc[3];
    int krow[3];
    bool ok[3];
    krow[0] = MROWS + lane; ok[0] = lane < NMETA;
    { const int s = t - 127 + lane; ok[1] = s >= 0; krow[1] = b * SEQ + s; }
    { const int s = t - 63 + lane; ok[2] = s >= 0; krow[2] = b * SEQ + s; }
#pragma unroll
    for (int p = 0; p < 3; ++p) {
        float a = -INFINITY;
        if (ok[p]) {
            const bf16_t* kp = PROJ + (size_t)krow[p] * INC + KOFF + kvh * 64;
            a = 0.f;
#pragma unroll
            for (int d = 0; d < 64; ++d) a += q[d] * bf2f(kp[d]);
            a *= 0.125f;
            if (p == 1) a -= slope * (float)(127 - lane);
            if (p == 2) a -= slope * (float)(63 - lane);
        }
        sc[p] = a;
    }
    const float sink = sinks[h];
    float m = wave_max(fmaxf(fmaxf(sc[0], sc[1]), sc[2]));
    m = fmaxf(m, sink);
    float pr[3]; float l = 0.f;
#pragma unroll
    for (int p = 0; p < 3; ++p) { pr[p] = ok[p] ? __expf(sc[p] - m) : 0.f; l += pr[p]; }
    l = wave_sum(l) + __expf(sink - m);
    const float inv = 1.f / l;
    float o = 0.f;
    for (int j = 0; j < NMETA; ++j) {
        const float p = __shfl(pr[0], j);
        o += p * bf2f(PROJ[(size_t)(MROWS + j) * INC + VOFF + kvh * 64 + lane]);
    }
    for (int j = 0; j < 64; ++j) {
        const int s = t - 127 + j;
        const float p = __shfl(pr[1], j);
        if (s >= 0) o += p * bf2f(PROJ[(size_t)(b * SEQ + s) * INC + VOFF + kvh * 64 + lane]);
    }
    for (int j = 0; j < 64; ++j) {
        const int s = t - 63 + j;
        const float p = __shfl(pr[2], j);
        if (s >= 0) o += p * bf2f(PROJ[(size_t)(b * SEQ + s) * INC + VOFF + kvh * 64 + lane]);
    }
    o *= inv;
    const float ss = wave_sum(o * o);
    if (lane == 0) red[h] = ss;
    __syncthreads();
    float tot = 0.f;
#pragma unroll
    for (int i = 0; i < 8; ++i) tot += red[i];
    const float rs = rsqrtf(tot * (1.f / AW) + EPS);
    const int c = h * 64 + lane;
    MIXED[(size_t)row * DM + c] = (bf16_t)f2bf(o * rs * og[c]);
}

__device__ __forceinline__ float block_sum512(float v, float* red) {
    const int w = threadIdx.x >> 6, lane = threadIdx.x & 63;
    v = wave_sum(v);
    __syncthreads();
    if (lane == 0) red[w] = v;
    __syncthreads();
    float t = 0.f;
#pragma unroll
    for (int i = 0; i < 8; ++i) t += red[i];
    return t;
}

__global__ void __launch_bounds__(512) k_conv(const bf16_t* __restrict__ PROJ, const float* __restrict__ cw, const float* __restrict__ cb, const float* __restrict__ lg,
                                              const float* __restrict__ lb, const float* __restrict__ og, bf16_t* __restrict__ MIXED) {
    __shared__ float red[8];
    const int row = blockIdx.x, b = row / SEQ, t = row % SEQ, c = threadIdx.x;
    float y = cb[c];
    for (int j = 0; j < 31; ++j) {
        const int pos = NMETA + t - 30 + j;
        if (pos < 0) continue;
        const size_t r = pos < NMETA ? (size_t)(MROWS + pos) : (size_t)(b * SEQ + pos - NMETA);
        const float a = bf2f(PROJ[r * INC + CAOFF + c]), g = bf2f(PROJ[r * INC + CGOFF + c]);
        y += cw[j * CW + c] * (a / (1.f + __expf(-g)));
    }
    const float mu = block_sum512(y, red) * (1.f / CW);
    const float dv = y - mu;
    const float var = block_sum512(dv * dv, red) * (1.f / CW);
    const float yn = dv * rsqrtf(var + EPS) * lg[c] + lb[c];
    const float s = yn / (1.f + __expf(-yn));
    const float ms = block_sum512(s * s, red) * (1.f / CW);
    MIXED[(size_t)row * DM + AW + c] = (bf16_t)f2bf(s * rsqrtf(ms + EPS) * og[c]);
}

extern "C" void kernel_launch(void* const* d_in, const int* in_sizes, int n_in, void* d_out, int out_size, void* d_ws, size_t ws_size, hipStream_t stream) {
    const float* x = (const float*)d_in[0];
    const float* meta = (const float*)d_in[1];
    const float* g1 = (const float*)d_in[2];
    const float* w_in = (const float*)d_in[3];
    const float* sinks = (const float*)d_in[4];
    const float* conv_w = (const float*)d_in[5];
    const float* conv_b = (const float*)d_in[6];
    const float* ln_g = (const float*)d_in[7];
    const float* ln_b = (const float*)d_in[8];
    const float* ao_g = (const float*)d_in[9];
    const float* co_g = (const float*)d_in[10];
    const float* w_out = (const float*)d_in[11];
    const float* g2 = (const float*)d_in[12];
    const float* w_gate = (const float*)d_in[13];
    const float* w_up = (const float*)d_in[14];
    const float* w_down = (const float*)d_in[15];
    const float* gf = (const float*)d_in[16];
    float* out = (float*)d_out;
    char* ws = (char*)d_ws;
    bf16_t* Wt_in = (bf16_t*)(ws + WS_WIN);
    bf16_t* Wt_out = (bf16_t*)(ws + WS_WOUT);
    bf16_t* Wt_gu = (bf16_t*)(ws + WS_WGU);
    bf16_t* Wt_dn = (bf16_t*)(ws + WS_WDN);
    bf16_t* XN = (bf16_t*)(ws + WS_XN);
    bf16_t* PROJ = (bf16_t*)(ws + WS_PROJ);
    bf16_t* MIXED = (bf16_t*)(ws + WS_MIXED);
    bf16_t* ACT = (bf16_t*)(ws + WS_ACT);

    k_transpose<<<dim3(INC / 32, DM / 32), dim3(32, 8), 0, stream>>>(w_in, DM, INC, Wt_in, 0);
    k_transpose<<<dim3(DM / 32, DM / 32), dim3(32, 8), 0, stream>>>(w_out, DM, DM, Wt_out, 0);
    k_transpose<<<dim3(DFF / 32, DM / 32), dim3(32, 8), 0, stream>>>(w_gate, DM, DFF, Wt_gu, 0);
    k_transpose<<<dim3(DFF / 32, DM / 32), dim3(32, 8), 0, stream>>>(w_up, DM, DFF, Wt_gu, DFF);
    k_transpose<<<dim3(DM / 32, DFF / 32), dim3(32, 8), 0, stream>>>(w_down, DFF, DM, Wt_dn, 0);
    k_rms_in<<<MPAD / 4, 256, 0, stream>>>(x, meta, g1, XN);
    k_gemm<0><<<dim3(INC / 128, MPAD / 128), 256, 0, stream>>>(XN, Wt_in, nullptr, DM, PROJ, INC, nullptr);
    k_attn<<<MROWS, 512, 0, stream>>>(PROJ, sinks, ao_g, MIXED);
    k_conv<<<MROWS, 512, 0, stream>>>(PROJ, conv_w, conv_b, ln_g, ln_b, co_g, MIXED);
    k_gemm<1><<<dim3(DM / 128, MROWS / 128), 256, 0, stream>>>(MIXED, Wt_out, nullptr, DM, out, DM, x);
    k_rms_row<true><<<MROWS / 4, 256, 0, stream>>>(out, g2, XN);
    k_gemm<2><<<dim3(DFF / 128, MROWS / 128), 256, 0, stream>>>(XN, Wt_gu, Wt_gu + (size_t)DFF * DM, DM, ACT, DFF, nullptr);
    k_gemm<1><<<dim3(DM / 128, MROWS / 128), 256, 0, stream>>>(ACT, Wt_dn, nullptr, DFF, out, DM, out);
    k_rms_row<false><<<MROWS / 4, 256, 0, stream>>>(out, gf, out);
}
```
